# Optimizing an MI355X kernel written in HIP

```python
import math
import jax, jax.numpy as jnp
from jax import lax
import numpy as np

D_MODEL = 1024
BATCH = 2
SEQ = 8192
DEPTH = 1

CHUNK = 64
D_MIX = D_MODEL
SB_HEADS = 8
SB_HEAD_DIM = 64
D_SB = SB_HEADS * SB_HEAD_DIM
CONV_GROUPS = 8
D_CONV = D_MIX - D_SB
CONV_WIDTH = 3
D_FF = 2816
Q_BLOCK = 128
EPS = 1e-6
D_IN = 3 * D_SB + 3 * D_CONV

kernel_name = "hybrid_stickbreaking_shortconv_macaron"


def rmsnorm(x, g):
    xf = x.astype(jnp.float32)
    y = xf * lax.rsqrt(jnp.mean(xf * xf, axis=-1, keepdims=True) + EPS)
    return (y * g.astype(jnp.float32)).astype(x.dtype)


def swiglu(h, w_gate, w_up, w_down):
    return (jax.nn.silu(h @ w_gate) * (h @ w_up)) @ w_down


def stick_breaking_attention(q, k, v):
    b, h, s, d = q.shape
    n_blk = s // Q_BLOCK
    scale = 1.0 / math.sqrt(d)
    kf = k.astype(jnp.float32)
    vf = v.astype(jnp.float32)
    key_pos = jnp.arange(s)
    q_blocks = q.reshape(b, h, n_blk, Q_BLOCK, d).transpose(2, 0, 1, 3, 4)

    def one_block(args):
        q_blk, blk = args
        z = jnp.einsum('bhqd,bhkd->bhqk', q_blk.astype(jnp.float32), kf) * scale
        q_pos = blk * Q_BLOCK + jnp.arange(Q_BLOCK)
        strict = key_pos[None, :] < q_pos[:, None]
        log_beta = jax.nn.log_sigmoid(z)
        log_keep = jnp.where(strict, log_beta - z, 0.0)
        later = lax.cumsum(log_keep, axis=3, reverse=True) - log_keep
        a = jnp.where(strict, jnp.exp(log_beta + later), 0.0)
        return jnp.einsum('bhqk,bhkd->bhqd', a, vf)

    out = lax.map(one_block, (q_blocks, jnp.arange(n_blk)))
    return out.transpose(1, 2, 0, 3, 4).reshape(b, h, s, d).astype(q.dtype)


def short_conv_mixer(gate_b, gate_c, u, conv_w, conv_b):
    s = u.shape[1]
    xc = gate_c * u
    pad = jnp.pad(xc, ((0, 0), (CONV_WIDTH - 1, 0), (0, 0)))
    y = conv_b
    for i in range(CONV_WIDTH):
        y = y + pad[:, i:i + s, :] * conv_w[i]
    return gate_b * y


def hybrid_mixer(h, w_in, conv_w, conv_b, sb_out_norm, conv_out_norm, w_out):
    b, s, _ = h.shape
    proj = h @ w_in
    q, k, v, gate_b, gate_c, u = jnp.split(
        proj, [D_SB, 2 * D_SB, 3 * D_SB, 3 * D_SB + D_CONV, 3 * D_SB + 2 * D_CONV], axis=-1)

    def heads(t):
        return t.reshape(b, s, SB_HEADS, SB_HEAD_DIM).transpose(0, 2, 1, 3)

    y_sb = stick_breaking_attention(heads(q), heads(k), heads(v))
    y_sb = y_sb.transpose(0, 2, 1, 3).reshape(b, s, D_SB)
    y_conv = short_conv_mixer(gate_b, gate_c, u, conv_w, conv_b)
    y = jnp.concatenate([rmsnorm(y_sb, sb_out_norm), rmsnorm(y_conv, conv_out_norm)], axis=-1)
    return y @ w_out


def setup_inputs(seed: int = 0) -> dict:
    key = jax.random.key(seed)
    ks = jax.random.split(key, 20)

    def w(k, shape, fan_in):
        return jax.random.normal(k, shape, jnp.float32) * fan_in ** -0.5

    def gain(k, shape):
        return 1.0 + 0.02 * jax.random.normal(k, shape, jnp.float32)

    return {
        "x": jax.random.normal(ks[0], (BATCH, SEQ, D_MODEL), jnp.float32),
        "ffn1_norm": gain(ks[1], (DEPTH, D_MODEL)),
        "ffn1_w_gate": w(ks[2], (DEPTH, D_MODEL, D_FF), D_MODEL),
        "ffn1_w_up": w(ks[3], (DEPTH, D_MODEL, D_FF), D_MODEL),
        "ffn1_w_down": w(ks[4], (DEPTH, D_FF, D_MODEL), D_FF),
        "mix_norm": gain(ks[5], (DEPTH, D_MODEL)),
        "w_in": w(ks[6], (DEPTH, D_MODEL, D_IN), D_MODEL),
        "conv_w": w(ks[7], (DEPTH, CONV_WIDTH, D_CONV), CONV_WIDTH),
        "conv_b": 0.01 * jax.random.normal(ks[8], (DEPTH, D_CONV), jnp.float32),
        "sb_out_norm": gain(ks[9], (DEPTH, D_SB)),
        "conv_out_norm": gain(ks[10], (DEPTH, D_CONV)),
        "w_out": w(ks[11], (DEPTH, D_MIX, D_MODEL), D_MIX),
        "ffn2_norm": gain(ks[12], (DEPTH, D_MODEL)),
        "ffn2_w_gate": w(ks[13], (DEPTH, D_MODEL, D_FF), D_MODEL),
        "ffn2_w_up": w(ks[14], (DEPTH, D_MODEL, D_FF), D_MODEL),
        "ffn2_w_down": w(ks[15], (DEPTH, D_FF, D_MODEL), D_FF),
        "final_norm": gain(ks[16], (D_MODEL,)),
    }


def reference(x, ffn1_norm, ffn1_w_gate, ffn1_w_up, ffn1_w_down, mix_norm, w_in, conv_w, conv_b,
              sb_out_norm, conv_out_norm, w_out, ffn2_norm, ffn2_w_gate, ffn2_w_up, ffn2_w_down,
              final_norm):
    for l in range(DEPTH):
        x = x + 0.5 * swiglu(rmsnorm(x, ffn1_norm[l]), ffn1_w_gate[l], ffn1_w_up[l], ffn1_w_down[l])
        x = x + hybrid_mixer(rmsnorm(x, mix_norm[l]), w_in[l], conv_w[l], conv_b[l],
                             sb_out_norm[l], conv_out_norm[l], w_out[l])
        x = x + 0.5 * swiglu(rmsnorm(x, ffn2_norm[l]), ffn2_w_gate[l], ffn2_w_up[l], ffn2_w_down[l])
    return rmsnorm(x, final_norm)
```

```cpp
#include <hip/hip_runtime.h>
#include <hip/hip_cooperative_groups.h>
#include <cstdio>
#include <cstdint>
namespace pg8 {
#define PG8_LAS __attribute__((address_space(3)))
typedef unsigned short bf16_t;
typedef short bf16x8 __attribute__((ext_vector_type(8)));
typedef float f32x4 __attribute__((ext_vector_type(4)));
typedef unsigned u32x4 __attribute__((ext_vector_type(4)));
constexpr int BM = 256, BK = 64, HALF = 128, HTB = HALF * BK * 2  , STAGE_BYTES = 8 * HTB, NXCD = 8, WGM = 8;

__host__ __device__ __forceinline__ int lds_byte(int r, int c) { const int st = (r >> 4) * 2 + (c >> 5), rr = r & 15, cc = c & 31, ob = rr * 64 + cc * 2; return st * 1024 + (ob ^ (((ob >> 9) & 1) << 5)); }
__host__ __device__ __forceinline__ void stage_rc(int b, int& R, int& C) { const int st = b / 1024, sb = b % 1024, swz = sb ^ (((sb >> 9) & 1) << 5); R = (st >> 1) * 16 + swz / 64; C = (st & 1) * 32 + (swz % 64) / 2; }
__host__ __device__ __forceinline__ int perm32(int rho) { const int n = rho >> 4, i = rho & 15; return 8 * (i >> 2) + 4 * n + (i & 3); }

struct Unit { int pm, pn; };
struct Gemm { const bf16_t* A; const bf16_t* Bt; int M, N, K; };

struct StaticOrder {
    int nM, nN, nwg, G, c;
    __host__ __device__ void init(int M, int N, int G_, int c_) { nM = M / BM; nN = N / BM; nwg = nM * nN; G = G_; c = c_; }
    __host__ __device__ bool next(int i, Unit& u) const {
        const long L = (long)i * G + c; if (L >= nwg) return false;
        int wgid = (int)L; { const int q = nwg / NXCD, r = nwg % NXCD, xcd = wgid % NXCD, off = wgid / NXCD; wgid = (xcd < r ? xcd * (q + 1) : r * (q + 1) + (xcd - r) * q) + off; }
        const int nig = WGM * nN, gid = wgid / nig, fm = gid * WGM, gsz = (nM - fm) < WGM ? (nM - fm) : WGM;
        u.pm = fm + ((wgid % nig) % gsz); u.pn = (wgid % nig) / gsz; return true;
    }
    __device__ __forceinline__ void a_ready(const Unit&) const {}
    __device__ __forceinline__ void done(const Unit&) const {}
};

__device__ __forceinline__ unsigned cvt_pk_bf16(float lo, float hi) { unsigned r; asm volatile("v_cvt_pk_bf16_f32 %0, %1, %2" : "=v"(r) : "v"(lo), "v"(hi)); return r; }
typedef float f32x2 __attribute__((ext_vector_type(2)));
__device__ __forceinline__ float row_rstd(const float* stats, int row) { const f32x4 s = *(const f32x4*)(stats + (size_t)row * 4); return __builtin_amdgcn_rsqf(((s[0] + s[1]) + (s[2] + s[3])) * (1.0f / 1024.0f) + 1e-6f); }
__device__ __forceinline__ float silu_mul(float g, float u) { return g * __builtin_amdgcn_rcpf(1.0f + __builtin_amdgcn_exp2f(g * -1.4426950408889634f)) * u; }
struct EpiSwiGLU {
    static constexpr bool PERM = true, AFTER_DRAIN = false;
    bf16_t* O; int ldc; const float* stats;
    __device__ __forceinline__ void operator()(const f32x4 (&acc)[2][2][4][2], const Unit& u, int wr, int wc, int fr, int fq) const {
        const int row0 = u.pm * BM + wr * 64 + fr, col0 = u.pn * HALF + wc * 32 + 8 * fq;
#pragma unroll
        for (int ai = 0; ai < 2; ++ai)
#pragma unroll
            for (int m = 0; m < 4; ++m) { const int row = row0 + ai * HALF + m * 16; const float r = row_rstd(stats, row);
                const f32x4 g0 = acc[ai][0][m][0] * r, g1 = acc[ai][0][m][1] * r, u0 = acc[ai][1][m][0] * r, u1 = acc[ai][1][m][1] * r;
                u32x4 w; w.x = cvt_pk_bf16(silu_mul(g0[0], u0[0]), silu_mul(g0[1], u0[1])); w.y = cvt_pk_bf16(silu_mul(g0[2], u0[2]), silu_mul(g0[3], u0[3]));
                w.z = cvt_pk_bf16(silu_mul(g1[0], u1[0]), silu_mul(g1[1], u1[1])); w.w = cvt_pk_bf16(silu_mul(g1[2], u1[2]), silu_mul(g1[3], u1[3]));
                *(u32x4*)(O + (size_t)row * ldc + col0) = w; }
    }
};
struct EpiScale {
    static constexpr bool PERM = true, AFTER_DRAIN = false;
    bf16_t* O; int ldc; const float* stats; int nq; float qscale;
    __device__ __forceinline__ void operator()(const f32x4 (&acc)[2][2][4][2], const Unit& u, int wr, int wc, int fr, int fq) const {
        const int row0 = u.pm * BM + wr * 64 + fr, col0 = u.pn * BM + wc * 32 + 8 * fq; const float qs = u.pn < nq ? qscale : 1.0f;
#pragma unroll
        for (int ai = 0; ai < 2; ++ai)
#pragma unroll
            for (int m = 0; m < 4; ++m) { const int row = row0 + ai * HALF + m * 16; const float r = row_rstd(stats, row) * qs; bf16_t* rowp = O + (size_t)row * ldc + col0;
#pragma unroll
                for (int bj = 0; bj < 2; ++bj) { const f32x4 v0 = acc[ai][bj][m][0] * r, v1 = acc[ai][bj][m][1] * r;
                    u32x4 w; w.x = cvt_pk_bf16(v0[0], v0[1]); w.y = cvt_pk_bf16(v0[2], v0[3]); w.z = cvt_pk_bf16(v1[0], v1[1]); w.w = cvt_pk_bf16(v1[2], v1[3]);
                    *(u32x4*)(rowp + bj * HALF) = w; } }
    }
};
struct EpiResid {
    static constexpr bool PERM = false, AFTER_DRAIN = true;
    const float* base; float* out; bf16_t* outb; float* stats_out; int ldc; float alpha;
    __device__ __forceinline__ void fused(f32x4 (&acc)[2][2][4][2], const Unit& u, int wr, int wc, int fr, int fq, PG8_LAS unsigned char* lds, int wid, int lane) const {
        typedef unsigned u32x2v __attribute__((ext_vector_type(2)));
        PG8_LAS float* P = (PG8_LAS float*)lds;
        const int col0 = u.pn * BM + wc * 32 + 4 * fq;
#pragma unroll
        for (int ai = 0; ai < 2; ++ai)
#pragma unroll
            for (int m = 0; m < 4; ++m) { const int r = ai * HALF + wr * 64 + m * 16 + fr; const size_t off = (size_t)(u.pm * BM + r) * ldc + col0; float ss = 0.f;
#pragma unroll
                for (int bj = 0; bj < 2; ++bj)
#pragma unroll
                    for (int n = 0; n < 2; ++n) { const f32x4 bs = *(const f32x4*)(base + off + bj * HALF + n * 16); const f32x4 v = bs + acc[ai][bj][m][n] * alpha;
                        *(f32x4*)(out + off + bj * HALF + n * 16) = v; ss += (v[0] * v[0] + v[1] * v[1]) + (v[2] * v[2] + v[3] * v[3]);
                        if (outb) { u32x2v w; w.x = cvt_pk_bf16(v[0], v[1]); w.y = cvt_pk_bf16(v[2], v[3]); *(u32x2v*)(outb + off + bj * HALF + n * 16) = w; } }
                ss += __shfl_xor(ss, 16); ss += __shfl_xor(ss, 32);
                if (fq == 0) P[r * 4 + wc] = ss;
                if (m & 1) asm volatile("" ::: "memory"); }
        asm volatile("s_waitcnt lgkmcnt(0)" ::: "memory"); __builtin_amdgcn_s_barrier(); asm volatile("" ::: "memory");
        const int tid = wid * 64 + lane;
        if (tid < 256) { const f32x4 p = *(const PG8_LAS f32x4*)(P + tid * 4); stats_out[(size_t)(u.pm * BM + tid) * 4 + u.pn] = (p[0] + p[1]) + (p[2] + p[3]); }
        asm volatile("s_waitcnt lgkmcnt(0)" ::: "memory"); __builtin_amdgcn_s_barrier(); asm volatile("" ::: "memory");
    }
};

template <class Epi, class Sched, bool ALIGN_EPI = false, bool SP2 = false>
__device__ __forceinline__ void gemm_phase(PG8_LAS unsigned char* lds, const Gemm g, const Sched& S, const Epi& E) {
    const int tid = threadIdx.x, wid = __builtin_amdgcn_readfirstlane(tid >> 6), lane = tid & 63, wr = wid >> 2, wc = wid & 3, fr = lane & 15, fq = lane >> 4;
    const int K = g.K, nt = K / BK;
    unsigned voffA[2], voffB[2];
#pragma unroll
    for (int i = 0; i < 2; ++i) { int R, C; stage_rc(tid * 16 + i * 8192, R, C); const int Rb = Epi::PERM ? ((R & ~31) + perm32(R & 31)) : R;
        voffA[i] = (unsigned)(R * K + C) * 2u; voffB[i] = (unsigned)(Rb * K + C) * 2u; }
    const size_t kstep = (size_t)(BK * 2);
    const size_t hstep = (size_t)HALF * K * 2;
    const size_t tstep = 2 * hstep;
    const unsigned ldsw = (unsigned)wid * 1024u;
    const int aoff = lds_byte(wr * 64 + fr, fq * 8), boff = lds_byte(wc * 32 + fr, fq * 8);
#define PG8_SA(b, h) (((b) * 2 + (h)) * HTB)
#define PG8_SB(b, h) ((4 + (b) * 2 + (h)) * HTB)
#define PG8_STAGE(bufoff, gbase, voff) do { _Pragma("unroll") for (int _i = 0; _i < 2; ++_i) \
        __builtin_amdgcn_global_load_lds((const unsigned*)((const char*)(gbase) + (voff)[_i]), (PG8_LAS unsigned*)(lds + (bufoff) + ldsw + _i * 8192), 16, 0, 0); } while (0)
#define PG8_LDA(dst, b, h) do { _Pragma("unroll") for (int m = 0; m < 4; ++m) _Pragma("unroll") for (int k = 0; k < 2; ++k) dst[m][k] = *(const PG8_LAS bf16x8*)(lds + PG8_SA(b, h) + aoff + m * 2048 + k * 1024); } while (0)
#define PG8_LDB(dst, b, h) do { _Pragma("unroll") for (int n = 0; n < 2; ++n) _Pragma("unroll") for (int k = 0; k < 2; ++k) dst[n][k] = *(const PG8_LAS bf16x8*)(lds + PG8_SB(b, h) + boff + n * 2048 + k * 1024); } while (0)
#define PG8_MMA(ai, bj, At, Bt) do { __builtin_amdgcn_s_setprio(1); _Pragma("unroll") for (int m = 0; m < 4; ++m) _Pragma("unroll") for (int n = 0; n < 2; ++n) _Pragma("unroll") for (int k = 0; k < 2; ++k) \
        acc[ai][bj][m][n] = __builtin_amdgcn_mfma_f32_16x16x32_bf16(Bt[n][k], At[m][k], acc[ai][bj][m][n], 0, 0, 0); __builtin_amdgcn_s_setprio(0); } while (0)
#define PG8_WAIT_V(n) asm volatile("s_waitcnt vmcnt(" #n ")" ::: "memory")
#define PG8_WAIT_L(n) asm volatile("s_waitcnt lgkmcnt(" #n ")" ::: "memory")
#define PG8_BAR __builtin_amdgcn_s_barrier()
#define PG8_SCHED __builtin_amdgcn_sched_barrier(0)
    Unit cur, nxt; int ui = 0;
    if (!S.next(0, cur)) return;
    f32x4 acc[2][2][4][2];
#pragma unroll
    for (int a = 0; a < 2; ++a)
#pragma unroll
        for (int b = 0; b < 2; ++b)
#pragma unroll
            for (int m = 0; m < 4; ++m)
#pragma unroll
                for (int n = 0; n < 2; ++n) acc[a][b][m][n] = (f32x4){0.f, 0.f, 0.f, 0.f};
    bf16x8 At[4][2], B0[2][2], B1[2][2];
    const char* cA = (const char*)g.A + (size_t)cur.pm * tstep; const char* cB = (const char*)g.Bt + (size_t)cur.pn * tstep;
    S.a_ready(cur);
    if constexpr (SP2) {
        PG8_STAGE(PG8_SB(0, 0), cB, voffB); PG8_STAGE(PG8_SB(0, 1), cB + hstep, voffB); PG8_STAGE(PG8_SA(0, 0), cA, voffA); PG8_STAGE(PG8_SA(0, 1), cA + hstep, voffA);
        if (wr == 1) PG8_BAR;
        PG8_WAIT_V(2); PG8_BAR;
        PG8_STAGE(PG8_SB(1, 0), cB + kstep, voffB); PG8_STAGE(PG8_SA(1, 0), cA + kstep, voffA); PG8_STAGE(PG8_SB(1, 1), cB + hstep + kstep, voffB);
        PG8_WAIT_V(6); PG8_BAR;
    } else {
        PG8_STAGE(PG8_SB(0, 0), cB, voffB); PG8_STAGE(PG8_SA(0, 0), cA, voffA); PG8_STAGE(PG8_SB(0, 1), cB + hstep, voffB); PG8_STAGE(PG8_SA(0, 1), cA + hstep, voffA);
        if (wr == 1) PG8_BAR;
        PG8_WAIT_V(4); PG8_BAR;
        PG8_STAGE(PG8_SB(1, 0), cB + kstep, voffB); PG8_STAGE(PG8_SA(1, 0), cA + kstep, voffA); PG8_STAGE(PG8_SB(1, 1), cB + hstep + kstep, voffB);
        PG8_WAIT_V(6); PG8_BAR;
    }
    for (;;) {
        const bool has_next = S.next(ui + 1, nxt);
        const char* nA = has_next ? (const char*)g.A + (size_t)nxt.pm * tstep : cA; const char* nB = has_next ? (const char*)g.Bt + (size_t)nxt.pn * tstep : cB;
        for (int t = 0; t < nt; t += 2) {
            const bool last = (t == nt - 2);
            const char* a1 = cA + (size_t)(t + 1) * kstep;
            const char* a2 = last ? nA : cA + (size_t)(t + 2) * kstep; const char* b2 = last ? nB : cB + (size_t)(t + 2) * kstep;
            const char* a3 = a2 + kstep; const char* b3 = b2 + kstep;
            if (last && has_next) S.a_ready(nxt);
            if constexpr (SP2) {
            PG8_LDB(B0, 0, 0); PG8_LDB(B1, 0, 1); PG8_SCHED; PG8_LDA(At, 0, 0); PG8_STAGE(PG8_SA(1, 1), a1 + hstep, voffA);
            PG8_WAIT_V(8); PG8_WAIT_L(0); PG8_BAR; PG8_MMA(0, 0, At, B0); PG8_MMA(0, 1, At, B1); PG8_BAR; PG8_SCHED;
            PG8_LDA(At, 0, 1); PG8_STAGE(PG8_SB(0, 0), b2, voffB); PG8_STAGE(PG8_SB(0, 1), b2 + hstep, voffB); PG8_STAGE(PG8_SA(0, 0), a2, voffA);
            PG8_WAIT_V(8); PG8_WAIT_L(0); PG8_BAR; PG8_MMA(1, 0, At, B0); PG8_MMA(1, 1, At, B1); PG8_BAR; PG8_SCHED;
            PG8_LDB(B0, 1, 0); PG8_LDB(B1, 1, 1); PG8_SCHED; PG8_LDA(At, 1, 0); PG8_STAGE(PG8_SA(0, 1), a2 + hstep, voffA);
            PG8_WAIT_V(8); PG8_WAIT_L(0); PG8_BAR; PG8_MMA(0, 0, At, B0); PG8_MMA(0, 1, At, B1); PG8_BAR; PG8_SCHED;
            PG8_LDA(At, 1, 1); PG8_STAGE(PG8_SB(1, 0), b3, voffB); PG8_STAGE(PG8_SB(1, 1), b3 + hstep, voffB); PG8_STAGE(PG8_SA(1, 0), a3, voffA);
            PG8_WAIT_V(8); PG8_WAIT_L(0); PG8_BAR; PG8_MMA(1, 0, At, B0); PG8_MMA(1, 1, At, B1); PG8_BAR; PG8_SCHED;
            } else {
            PG8_LDB(B0, 0, 0); PG8_SCHED; PG8_LDA(At, 0, 0); PG8_STAGE(PG8_SA(1, 1), a1 + hstep, voffA);
            PG8_WAIT_L(8); PG8_BAR; PG8_WAIT_L(0); PG8_MMA(0, 0, At, B0); PG8_BAR; PG8_SCHED;
            PG8_LDB(B1, 0, 1); PG8_STAGE(PG8_SB(0, 0), b2, voffB);
            PG8_BAR; PG8_WAIT_L(0); PG8_MMA(0, 1, At, B1); PG8_BAR;
            PG8_LDA(At, 0, 1); PG8_STAGE(PG8_SA(0, 0), a2, voffA);
            PG8_BAR; PG8_WAIT_L(0); PG8_MMA(1, 0, At, B0); PG8_BAR; PG8_SCHED;
            PG8_STAGE(PG8_SB(0, 1), b2 + hstep, voffB);
            PG8_WAIT_V(6); PG8_BAR; PG8_MMA(1, 1, At, B1); PG8_BAR;
            PG8_LDB(B0, 1, 0); PG8_SCHED; PG8_LDA(At, 1, 0); PG8_STAGE(PG8_SA(0, 1), a2 + hstep, voffA);
            PG8_WAIT_L(8); PG8_BAR; PG8_WAIT_L(0); PG8_MMA(0, 0, At, B0); PG8_BAR; PG8_SCHED;
            PG8_LDB(B1, 1, 1); PG8_STAGE(PG8_SB(1, 0), b3, voffB);
            PG8_BAR; PG8_WAIT_L(0); PG8_MMA(0, 1, At, B1); PG8_BAR;
            PG8_LDA(At, 1, 1); PG8_STAGE(PG8_SA(1, 0), a3, voffA);
            PG8_BAR; PG8_WAIT_L(0); PG8_MMA(1, 0, At, B0); PG8_BAR; PG8_SCHED;
            PG8_STAGE(PG8_SB(1, 1), b3 + hstep, voffB);
            PG8_WAIT_V(6); PG8_BAR; PG8_MMA(1, 1, At, B1); PG8_BAR;
            }
        }
        if constexpr (ALIGN_EPI) { if (wr == 0) PG8_BAR; }
        if constexpr (!Epi::AFTER_DRAIN) { E(acc, cur, wr, wc, fr, fq); S.done(cur); }
        if (!has_next) break;
#pragma unroll
        for (int a = 0; a < 2; ++a)
#pragma unroll
            for (int b = 0; b < 2; ++b)
#pragma unroll
                for (int m = 0; m < 4; ++m)
#pragma unroll
                    for (int n = 0; n < 2; ++n) acc[a][b][m][n] = (f32x4){0.f, 0.f, 0.f, 0.f};
        cur = nxt; cA = nA; cB = nB; ++ui;
        if constexpr (ALIGN_EPI) { if (wr == 1) PG8_BAR; }
    }
    PG8_WAIT_V(0);
    if constexpr (!ALIGN_EPI) { if (wr == 0) PG8_BAR; }
    PG8_BAR;
    if constexpr (Epi::AFTER_DRAIN) { E.fused(acc, cur, wr, wc, fr, fq, lds, wid, lane); S.done(cur); }
#undef PG8_SA
#undef PG8_SB
#undef PG8_STAGE
#undef PG8_LDA
#undef PG8_LDB
#undef PG8_MMA
#undef PG8_WAIT_V
#undef PG8_WAIT_L
#undef PG8_BAR
#undef PG8_SCHED
}
}
namespace mix {
typedef unsigned short bf16_t;
typedef short bf16x8 __attribute__((ext_vector_type(8)));
typedef short s16x4 __attribute__((ext_vector_type(4)));
typedef float f32x16 __attribute__((ext_vector_type(16)));
typedef float f32x4 __attribute__((ext_vector_type(4)));
typedef unsigned u32x4 __attribute__((ext_vector_type(4)));
#define MIX_LAS __attribute__((address_space(3)))
constexpr int SEQ = 8192, PITCH = 3072, KOFF = 512, VOFF = 1024, BOFF = 1536, COFF = 2048, UOFF = 2560, YP = 1024;
constexpr float EXIT_THR = 152.0f;
constexpr int LDS_V = 0, LDS_SS = 131072, LDS_BYTES = 131072 + 1024;
__device__ __forceinline__ void glds16(const void* gsrc, unsigned lds_dst) { unsigned keep;
    asm volatile("s_mov_b32 %0, m0\n\ts_mov_b32 m0, %2\n\ts_nop 0\n\tglobal_load_lds_dwordx4 %1, off\n\ts_mov_b32 m0, %0" : "=&s"(keep) : "v"(gsrc), "s"(lds_dst) : "memory"); }
#define MIX_SBAR() __builtin_amdgcn_sched_barrier(0)
__device__ __forceinline__ unsigned cvtpk(float lo, float hi) { unsigned r; asm("v_cvt_pk_bf16_f32 %0, %1, %2" : "=v"(r) : "v"(lo), "v"(hi)); return r; }
__device__ __forceinline__ float bf_lo(unsigned w) { return __uint_as_float(w << 16); }
__device__ __forceinline__ float bf_hi(unsigned w) { return __uint_as_float(w & 0xffff0000u); }

__device__ __forceinline__ void pv(f32x16* o, int vb, bf16x8 pa0, bf16x8 pa1, bf16x8 pa2, bf16x8 pa3) {
#pragma unroll
    for (int d0 = 0; d0 < 2; ++d0) { s16x4 lo[4], hi[4];
#pragma unroll
        for (int ks = 0; ks < 4; ++ks) {
            asm volatile("ds_read_b64_tr_b16 %0,%1 offset:%c2" : "=&v"(lo[ks]) : "v"(vb), "i"(d0 * 4096 + ks * 1024) : "memory");
            asm volatile("ds_read_b64_tr_b16 %0,%1 offset:%c2" : "=&v"(hi[ks]) : "v"(vb), "i"(d0 * 4096 + ks * 1024 + 512) : "memory"); }
        asm volatile("s_waitcnt lgkmcnt(0)" ::: "memory"); MIX_SBAR();
#define MIX_PK(k) (bf16x8){lo[k][0], lo[k][1], lo[k][2], lo[k][3], hi[k][0], hi[k][1], hi[k][2], hi[k][3]}
        o[d0] = __builtin_amdgcn_mfma_f32_32x32x16_bf16(pa0, MIX_PK(0), o[d0], 0, 0, 0);
        o[d0] = __builtin_amdgcn_mfma_f32_32x32x16_bf16(pa1, MIX_PK(1), o[d0], 0, 0, 0);
        o[d0] = __builtin_amdgcn_mfma_f32_32x32x16_bf16(pa2, MIX_PK(2), o[d0], 0, 0, 0);
        o[d0] = __builtin_amdgcn_mfma_f32_32x32x16_bf16(pa3, MIX_PK(3), o[d0], 0, 0, 0);
#undef MIX_PK
    }
}

__device__ __forceinline__ void tile_math(const f32x16& p0, const f32x16& p1, float& R, int hi, u32x4& pw0, u32x4& pw1, u32x4& pw2, u32x4& pw3) {
    float sp[32], ex[32], bs[8], OS[9], base[8], A[32];
#pragma unroll
    for (int i = 0; i < 32; ++i) { const float z = i < 16 ? p0[i] : p1[i - 16];
        const float e = __builtin_amdgcn_exp2f(-__builtin_fabsf(z)), l = __builtin_amdgcn_logf(1.0f + e); float s = __builtin_fmaxf(z, 0.f) + l;
        sp[i] = s; }
#pragma unroll
    for (int G = 0; G < 8; ++G) { const int b = 4 * G; ex[b + 3] = 0.f; ex[b + 2] = sp[b + 3]; ex[b + 1] = ex[b + 2] + sp[b + 2]; ex[b] = ex[b + 1] + sp[b + 1]; bs[G] = ex[b] + sp[b]; }
    OS[8] = 0.f;
#pragma unroll
    for (int G = 7; G >= 0; --G) OS[G] = OS[G + 1] + bs[G];
#pragma unroll
    for (int G = 0; G < 8; ++G) { auto rr = __builtin_amdgcn_permlane32_swap(__float_as_uint(OS[G]), __float_as_uint(OS[G + 1]), false, false);
        const float X = hi ? __uint_as_float(rr[0]) : __uint_as_float(rr[1]); base[G] = (R + OS[G + 1]) + X; }
    { auto rr = __builtin_amdgcn_permlane32_swap(__float_as_uint(OS[0]), __float_as_uint(OS[0]), false, false); R += __uint_as_float(rr[0]) + __uint_as_float(rr[1]); }
#pragma unroll
    for (int i = 0; i < 32; ++i) { const float z = i < 16 ? p0[i] : p1[i - 16];
        const float sn = sp[i] - z;
        float a = __builtin_amdgcn_exp2f(-(sn + (base[i >> 2] + ex[i])));
        A[i] = a; }
    pw0 = (u32x4){cvtpk(A[0], A[1]), cvtpk(A[2], A[3]), cvtpk(A[4], A[5]), cvtpk(A[6], A[7])};
    pw1 = (u32x4){cvtpk(A[8], A[9]), cvtpk(A[10], A[11]), cvtpk(A[12], A[13]), cvtpk(A[14], A[15])};
    pw2 = (u32x4){cvtpk(A[16], A[17]), cvtpk(A[18], A[19]), cvtpk(A[20], A[21]), cvtpk(A[22], A[23])};
    pw3 = (u32x4){cvtpk(A[24], A[25]), cvtpk(A[26], A[27]), cvtpk(A[28], A[29]), cvtpk(A[30], A[31])};
}

struct Tensors { const bf16_t* P; bf16_t* Y; const float* conv_w; const float* conv_b; };

__device__ __forceinline__ void mix_unit(int unit, const Tensors& T, MIX_LAS unsigned char* shm) {
    const int tid = threadIdx.x, lane = tid & 63, r32 = lane & 31, hi = lane >> 5; const int wid = __builtin_amdgcn_readfirstlane(tid >> 6);
    const int g0 = unit * 32, t0 = g0 % SEQ; const size_t rowbase = (size_t)(g0 - t0);
    const int h = wid;
    MIX_LAS unsigned char* slot = shm + LDS_V + wid * 16384;
    MIX_LAS float* sstab = (MIX_LAS float*)(shm + LDS_SS);
    {
        bf16x8 qr[4];
        { const bf16_t* Qp = T.P + (size_t)(g0 + r32) * PITCH + h * 64 + hi * 8;
#pragma unroll
          for (int d0 = 0; d0 < 4; ++d0) qr[d0] = *(const bf16x8*)(Qp + d0 * 16); }
        const bf16_t* Kl = T.P + (rowbase + r32) * PITCH + KOFF + h * 64 + hi * 8;
        const bf16_t* Vl = T.P + (rowbase + (lane >> 2)) * PITCH + VOFF + h * 64 + (lane & 3) * 8;
        const int jd = t0 >> 6, doff = (t0 & 63) + r32;
        const int vb = (int)(unsigned)(uintptr_t)slot + 8192 + ((lane >> 4) & 1) * 32 + (lane & 3) * 8 + (4 * hi + ((lane & 15) >> 2)) * 64;
        const unsigned kslot_u = (unsigned)__builtin_amdgcn_readfirstlane((int)(unsigned)(uintptr_t)slot), vslot_u = kslot_u + 8192u;
#define MIX_DMAK(j) do { const bf16_t* kp_ = Kl + (size_t)(j) * 64 * PITCH; \
        _Pragma("unroll") for (int p = 0; p < 8; ++p) glds16(kp_ + (size_t)(32 * (p & 1)) * PITCH + 16 * (p >> 1), kslot_u + p * 1024); } while (0)
#define MIX_DMAV(j) do { const bf16_t* vp_ = Vl + (size_t)(j) * 64 * PITCH; \
        _Pragma("unroll") for (int p = 0; p < 8; ++p) glds16(vp_ + (size_t)(16 * (p & 3)) * PITCH + 32 * (p >> 2), vslot_u + p * 1024); } while (0)
        MIX_DMAK(jd); MIX_DMAV(jd);
        float R = 0.f; f32x16 o[2]; o[0] = f32x16{}; o[1] = f32x16{};
        for (int j = jd;; --j) {
            asm volatile("s_waitcnt vmcnt(8)" ::: "memory");
            bf16x8 kf[8];
#pragma unroll
            for (int p = 0; p < 8; ++p) kf[p] = *(const MIX_LAS bf16x8*)(slot + p * 1024 + lane * 16);
            f32x16 p0 = f32x16{}, p1 = f32x16{};
#pragma unroll
            for (int d0 = 0; d0 < 4; ++d0) { p0 = __builtin_amdgcn_mfma_f32_32x32x16_bf16(kf[2 * d0], qr[d0], p0, 0, 0, 0); p1 = __builtin_amdgcn_mfma_f32_32x32x16_bf16(kf[2 * d0 + 1], qr[d0], p1, 0, 0, 0); }
            asm volatile("s_waitcnt lgkmcnt(0)" ::: "memory");
            if (j > 0) MIX_DMAK(j - 1);
            if (j == jd) {
#pragma unroll
                for (int i = 0; i < 16; ++i) { const int key = 8 * (i >> 2) + (i & 3) + 4 * hi; p0[i] = key < doff ? p0[i] : -1e30f; p1[i] = key + 32 < doff ? p1[i] : -1e30f; } }
            u32x4 pw0, pw1, pw2, pw3;
            tile_math(p0, p1, R, hi, pw0, pw1, pw2, pw3);
            if (j > 0) asm volatile("s_waitcnt vmcnt(8)" ::: "memory"); else asm volatile("s_waitcnt vmcnt(0)" ::: "memory");
            pv(o, vb, __builtin_bit_cast(bf16x8, pw0), __builtin_bit_cast(bf16x8, pw1), __builtin_bit_cast(bf16x8, pw2), __builtin_bit_cast(bf16x8, pw3));
            if (j == 0 || __all(R > EXIT_THR)) break;
            MIX_DMAV(j - 1);
        }
#undef MIX_DMAK
#undef MIX_DMAV
        asm volatile("s_waitcnt vmcnt(0)" ::: "memory");
        MIX_LAS float* stg = (MIX_LAS float*)slot;
#pragma unroll
        for (int r = 0; r < 16; ++r) { const int q = (r & 3) + 8 * (r >> 2) + 4 * hi; stg[q * 64 + r32] = o[0][r]; stg[q * 64 + 32 + r32] = o[1][r]; }
        asm volatile("s_waitcnt lgkmcnt(0)" ::: "memory");
    }
    const int orow = lane >> 1, ohalf = lane & 1;
    f32x4 ov[8]; float ss = 0.f;
    { const MIX_LAS f32x4* sp = (const MIX_LAS f32x4*)(slot + orow * 256 + ohalf * 128);
#pragma unroll
      for (int i = 0; i < 8; ++i) { ov[i] = sp[i]; ss += (ov[i][0] * ov[i][0] + ov[i][1] * ov[i][1]) + (ov[i][2] * ov[i][2] + ov[i][3] * ov[i][3]); } }
    ss += __shfl_xor(ss, 1);
    if (ohalf == 0) sstab[h * 32 + orow] = ss;
    asm volatile("s_waitcnt lgkmcnt(0)" ::: "memory"); __builtin_amdgcn_s_barrier(); asm volatile("" ::: "memory");
    { float tot = 0.f;
#pragma unroll
      for (int hh = 0; hh < 8; ++hh) tot += sstab[hh * 32 + orow];
      const float rs = __builtin_amdgcn_rsqf(tot * (1.0f / 512.0f) + 1e-6f);
      bf16_t* yp = T.Y + (size_t)(g0 + orow) * YP + h * 64 + ohalf * 32;
#pragma unroll
      for (int i = 0; i < 4; ++i) { const f32x4 a = ov[2 * i] * rs, b = ov[2 * i + 1] * rs;
          *(u32x4*)(yp + i * 8) = (u32x4){cvtpk(a[0], a[1]), cvtpk(a[2], a[3]), cvtpk(b[0], b[1]), cvtpk(b[2], b[3])}; } }
    {
        const int c0 = lane * 8;
        float w0[8], w1[8], w2[8], bb[8];
#pragma unroll
        for (int i = 0; i < 2; ++i) { const f32x4 a = *(const f32x4*)(T.conv_w + c0 + 4 * i), b = *(const f32x4*)(T.conv_w + 512 + c0 + 4 * i), c = *(const f32x4*)(T.conv_w + 1024 + c0 + 4 * i), d = *(const f32x4*)(T.conv_b + c0 + 4 * i);
#pragma unroll
            for (int k = 0; k < 4; ++k) { w0[4 * i + k] = a[k]; w1[4 * i + k] = b[k]; w2[4 * i + k] = c[k]; bb[4 * i + k] = d[k]; } }
        const int tq = t0 + 4 * wid;
        float xm2[8], xm1[8];
#define MIX_XC(dst, grow, valid) do { if (valid) { const u32x4 cc = *(const u32x4*)(T.P + (size_t)(grow) * PITCH + COFF + c0), uu = *(const u32x4*)(T.P + (size_t)(grow) * PITCH + UOFF + c0); \
            _Pragma("unroll") for (int k = 0; k < 4; ++k) { dst[2 * k] = bf_lo(cc[k]) * bf_lo(uu[k]); dst[2 * k + 1] = bf_hi(cc[k]) * bf_hi(uu[k]); } } \
          else { _Pragma("unroll") for (int k = 0; k < 8; ++k) dst[k] = 0.f; } } while (0)
        const size_t gq = (size_t)g0 + 4 * wid;
        MIX_XC(xm2, gq - 2, tq >= 2); MIX_XC(xm1, gq - 1, tq >= 1);
#pragma unroll
        for (int i = 0; i < 4; ++i) { float xc[8]; MIX_XC(xc, gq + i, true);
            const u32x4 gb = *(const u32x4*)(T.P + (gq + i) * PITCH + BOFF + c0); float y[8]; float s2 = 0.f;
#pragma unroll
            for (int k = 0; k < 8; ++k) { const float gate = (k & 1) ? bf_hi(gb[k >> 1]) : bf_lo(gb[k >> 1]);
                y[k] = gate * (bb[k] + w0[k] * xm2[k] + w1[k] * xm1[k] + w2[k] * xc[k]); s2 += y[k] * y[k]; }
#pragma unroll
            for (int o_ = 1; o_ < 64; o_ <<= 1) s2 += __shfl_xor(s2, o_);
            const float rs = __builtin_amdgcn_rsqf(s2 * (1.0f / 512.0f) + 1e-6f);
            *(u32x4*)(T.Y + (gq + i) * YP + 512 + c0) = (u32x4){cvtpk(y[0] * rs, y[1] * rs), cvtpk(y[2] * rs, y[3] * rs), cvtpk(y[4] * rs, y[5] * rs), cvtpk(y[6] * rs, y[7] * rs)};
#pragma unroll
            for (int k = 0; k < 8; ++k) { xm2[k] = xm1[k]; xm1[k] = xc[k]; } }
#undef MIX_XC
    }
    asm volatile("s_waitcnt lgkmcnt(0)" ::: "memory"); __builtin_amdgcn_s_barrier(); asm volatile("" ::: "memory");
}
#undef MIX_SBAR
}

namespace cg = cooperative_groups;
constexpr int NWAVES = 8;
#define MK_PER_PHASE 1
#ifndef MK_PER_PHASE
#define MK_PER_PHASE 0
#endif
constexpr int N_PHASES = 9;
constexpr int BATCH = 2, T = 8192, D = 1024, M = BATCH * T, FF = 2816, NGU = 2 * FF, DIN = 3072, DSB = 512;
constexpr float C2 = 0.125f * 1.4426950408889634f;
constexpr size_t MiB = 1u << 20;
constexpr size_t WS_ST0 = 1 * MiB, WS_ST1 = WS_ST0 + 256 * 1024, WS_ST2 = WS_ST1 + 256 * 1024, WS_ST3 = WS_ST2 + 256 * 1024;
constexpr size_t WS_W1P = 2 * MiB, WS_W1D = 13 * MiB, WS_WIN = 19 * MiB, WS_WOUT = 25 * MiB, WS_W2P = 27 * MiB, WS_W2D = 38 * MiB;
constexpr size_t WS_XB = 44 * MiB;
constexpr size_t WS_YN = 76 * MiB;
constexpr size_t WS_ACT = 108 * MiB;
constexpr size_t WS_END = 204 * MiB;
static_assert(WS_W1P + (size_t)NGU * D * 2 <= WS_W1D && WS_W1D + (size_t)D * FF * 2 <= WS_WIN && WS_WIN + (size_t)DIN * D * 2 <= WS_WOUT && WS_WOUT + (size_t)D * D * 2 <= WS_W2P &&
              WS_W2P + (size_t)NGU * D * 2 <= WS_W2D && WS_W2D + (size_t)D * FF * 2 <= WS_XB && WS_XB + (size_t)M * D * 2 <= WS_YN && WS_YN + (size_t)M * D * 2 <= WS_ACT &&
              WS_ACT + (size_t)M * DIN * 2 <= WS_END && WS_ST3 + 256 * 1024 <= WS_W1P, "d_ws map");
constexpr int RING_BYTES = 131072, LDS_BYTES = 131072 + 1024;
static_assert(mix::LDS_BYTES <= LDS_BYTES && pg8::STAGE_BYTES == RING_BYTES, "LDS map");

#define GAS __attribute__((address_space(1)))
#define LAS __attribute__((address_space(3)))
typedef unsigned short bf16;
typedef unsigned v4u __attribute__((ext_vector_type(4)));
typedef float f32x4 __attribute__((ext_vector_type(4)));
#define LDS_WAIT() asm volatile("s_waitcnt lgkmcnt(0)" ::: "memory")
__device__ __forceinline__ unsigned pk2(float lo, float hi) { unsigned r; asm("v_cvt_pk_bf16_f32 %0, %1, %2" : "=v"(r) : "v"(lo), "v"(hi)); return r; }
__device__ __forceinline__ float wave_sum(float v) {
#pragma unroll
    for (int o = 1; o < 64; o <<= 1) v += __shfl_xor(v, o);
    return v;
}
__device__ __forceinline__ void p0_transpose_item(const float* W, int K, int N, bf16* WT, int k0, int n0, int orow0, const float* gk, LAS float* scr, int lane) {
#pragma unroll 8
    for (int i = 0; i < 32; ++i) { const int kk = 2 * i + (lane >> 5); const float g = gk ? gk[kk] : 1.0f; scr[kk * 33 + (lane & 31)] = W[(size_t)(k0 + kk) * N + n0 + (lane & 31)] * g; }
    LDS_WAIT(); asm volatile("" ::: "memory");
    const int c = lane & 7;
#pragma unroll
    for (int j = 0; j < 4; ++j) { const int n = (lane >> 3) + 8 * j; const LAS float* s = scr + (8 * c) * 33 + n;
        v4u o; o.x = pk2(s[0 * 33], s[1 * 33]); o.y = pk2(s[2 * 33], s[3 * 33]); o.z = pk2(s[4 * 33], s[5 * 33]); o.w = pk2(s[6 * 33], s[7 * 33]);
        *(GAS v4u*)(WT + (size_t)(orow0 + n) * K + k0 + 8 * c) = o; }
    LDS_WAIT(); asm volatile("" ::: "memory");
}
struct Args { const float* in[17]; float* out; unsigned char* ws; int ph_lo, ph_hi; };

__global__ void __launch_bounds__(NWAVES * 64, 2) hybrid_fwd(Args args) {
    extern __shared__ __attribute__((aligned(16))) unsigned char lds_raw[];
    LAS unsigned char* lds = (LAS unsigned char*)lds_raw;
    const int tid = threadIdx.x, lane = tid & 63, wave = __builtin_amdgcn_readfirstlane(tid >> 6);
    const int G = gridDim.x, bx = blockIdx.x;
    const int vcu = (G % 8 == 0) ? (bx % 8) * (G / 8) + bx / 8 : bx;
    const int gw = vcu * NWAVES + wave, NGW = G * NWAVES;
    unsigned char* ws = args.ws;
    const float* x = args.in[0]; float* out = args.out;
    float* st0 = (float*)(ws + WS_ST0); float* st1 = (float*)(ws + WS_ST1); float* st2 = (float*)(ws + WS_ST2); float* st3 = (float*)(ws + WS_ST3);
    bf16* W1P = (bf16*)(ws + WS_W1P); bf16* W1D = (bf16*)(ws + WS_W1D); bf16* WIN = (bf16*)(ws + WS_WIN); bf16* WOUT = (bf16*)(ws + WS_WOUT); bf16* W2P = (bf16*)(ws + WS_W2P); bf16* W2D = (bf16*)(ws + WS_W2D);
    bf16* XB = (bf16*)(ws + WS_XB); bf16* YN = (bf16*)(ws + WS_YN); bf16* ACT = (bf16*)(ws + WS_ACT);
    const int lo = args.ph_lo, hi = args.ph_hi;
#define IN(k) (lo <= (k) && (k) < hi)
#define SEAM(k) do { if (IN(k) && IN((k) + 1)) cg::this_grid().sync(); } while (0)

    if (IN(0)) {
        LAS float* scr = (LAS float*)(lds + wave * 16384);
        constexpr int I_GU = (D / 64) * (FF / 32), I_DN = (FF / 64) * (D / 32), I_IN = (D / 64) * (DIN / 32), I_OUT = (D / 64) * (D / 32);
        constexpr int NITEMS = 4 * I_GU + 2 * I_DN + I_IN + I_OUT;
        for (int it = gw; it < NITEMS; it += NGW) {
            int r = it;
            if (r < 4 * I_GU) {
                const int which = r / I_GU; r -= which * I_GU; const int nblk = FF / 32, kb = r / nblk, nb = r % nblk, n0 = 32 * nb;
                const float* W = args.in[which == 0 ? 2 : which == 1 ? 3 : which == 2 ? 13 : 14]; const float* gn = args.in[which < 2 ? 1 : 12];
                p0_transpose_item(W, D, FF, which < 2 ? W1P : W2P, 64 * kb, n0, 256 * (n0 >> 7) + (n0 & 127) + ((which & 1) ? 128 : 0), gn + 64 * kb, scr, lane); continue; }
            r -= 4 * I_GU;
            if (r < 2 * I_DN) { const int which = r / I_DN; r -= which * I_DN; const int nblk = D / 32, kb = r / nblk, nb = r % nblk;
                p0_transpose_item(args.in[which ? 15 : 4], FF, D, which ? W2D : W1D, 64 * kb, 32 * nb, 32 * nb, nullptr, scr, lane); continue; }
            r -= 2 * I_DN;
            if (r < I_IN) { const int nblk = DIN / 32, kb = r / nblk, nb = r % nblk; p0_transpose_item(args.in[6], D, DIN, WIN, 64 * kb, 32 * nb, 32 * nb, args.in[5] + 64 * kb, scr, lane); continue; }
            r -= I_IN;
            { const int nblk = D / 32, kb = r / nblk, nb = r % nblk; const int k0 = 64 * kb;
              p0_transpose_item(args.in[11], D, D, WOUT, k0, 32 * nb, 32 * nb, k0 < DSB ? args.in[9] + k0 : args.in[10] + (k0 - DSB), scr, lane); }
        }
        for (int m = gw; m < M; m += NGW) {
            const GAS f32x4* xr = (const GAS f32x4*)(x + (size_t)m * D) + lane; f32x4 v[4]; float s = 0.f;
#pragma unroll
            for (int j = 0; j < 4; ++j) { v[j] = xr[64 * j]; s += (v[j].x * v[j].x + v[j].y * v[j].y) + (v[j].z * v[j].z + v[j].w * v[j].w); }
            s = wave_sum(s);
            GAS unsigned long long* o8 = (GAS unsigned long long*)(XB + (size_t)m * D) + lane;
#pragma unroll
            for (int j = 0; j < 4; ++j) o8[64 * j] = (unsigned long long)pk2(v[j].x, v[j].y) | ((unsigned long long)pk2(v[j].z, v[j].w) << 32);
            if (lane == 0) *(f32x4*)(st0 + (size_t)m * 4) = (f32x4){s, 0.f, 0.f, 0.f};
        }
        __syncthreads();
    }
    SEAM(0);
    if (IN(1)) { pg8::Gemm g{XB, W1P, M, NGU, D}; pg8::StaticOrder S; S.init(M, NGU, G, bx); pg8::EpiSwiGLU E{ACT, FF, st0};
        pg8::gemm_phase<pg8::EpiSwiGLU, pg8::StaticOrder, true, true>(lds, g, S, E); }
    SEAM(1);
    if (IN(2)) { pg8::Gemm g{ACT, W1D, M, D, FF}; pg8::StaticOrder S; S.init(M, D, G, bx); pg8::EpiResid E{x, out, XB, st1, D, 0.5f};
        pg8::gemm_phase<pg8::EpiResid, pg8::StaticOrder, false, true>(lds, g, S, E); }
    SEAM(2);
    if (IN(3)) { pg8::Gemm g{XB, WIN, M, DIN, D}; pg8::StaticOrder S; S.init(M, DIN, G, bx); pg8::EpiScale E{ACT, DIN, st1, DSB / 256, C2};
        pg8::gemm_phase<pg8::EpiScale, pg8::StaticOrder, true, true>(lds, g, S, E); }
    SEAM(3);
    if (IN(4)) { const mix::Tensors MT{ACT, YN, args.in[7], args.in[8]};
        for (int u = vcu; u < M / 32; u += G) mix::mix_unit(u, MT, lds); }
    SEAM(4);
    if (IN(5)) { pg8::Gemm g{YN, WOUT, M, D, D}; pg8::StaticOrder S; S.init(M, D, G, bx); pg8::EpiResid E{out, out, XB, st2, D, 1.0f};
        pg8::gemm_phase<pg8::EpiResid, pg8::StaticOrder, false, true>(lds, g, S, E); }
    SEAM(5);
    if (IN(6)) { pg8::Gemm g{XB, W2P, M, NGU, D}; pg8::StaticOrder S; S.init(M, NGU, G, bx); pg8::EpiSwiGLU E{ACT, FF, st2};
        pg8::gemm_phase<pg8::EpiSwiGLU, pg8::StaticOrder, true, true>(lds, g, S, E); }
    SEAM(6);
    if (IN(7)) { pg8::Gemm g{ACT, W2D, M, D, FF}; pg8::StaticOrder S; S.init(M, D, G, bx); pg8::EpiResid E{out, out, nullptr, st3, D, 0.5f};
        pg8::gemm_phase<pg8::EpiResid, pg8::StaticOrder, false, true>(lds, g, S, E); }
    SEAM(7);
    if (IN(8)) {
        const float* gn = args.in[16];
        for (int m = gw; m < M; m += NGW) {
            GAS f32x4* xr = (GAS f32x4*)(out + (size_t)m * D) + lane; const float r = pg8::row_rstd(st3, m);
#pragma unroll
            for (int j = 0; j < 4; ++j) { const f32x4 v = xr[64 * j], gg = *((const f32x4*)gn + lane + 64 * j); xr[64 * j] = v * r * gg; }
        }
    }
#undef IN
#undef SEAM
}

extern "C" void kernel_launch(void* const* d_in, const int* in_sizes, int n_in, void* d_out, int out_size, void* d_ws, size_t ws_size, hipStream_t stream) {
    static int ready = 0;
    if (ready == 0) {
        if (n_in != 17 || in_sizes[0] != M * D || out_size != M * D || ws_size < WS_END) { fprintf(stderr, "kernel_launch: unexpected shapes (n_in %d, in0 %d, out %d, ws %zu); nothing launched\n", n_in, n_in > 0 ? in_sizes[0] : -1, out_size, ws_size); ready = -1; return; }
        if (hipFuncSetAttribute((const void*)hybrid_fwd, hipFuncAttributeMaxDynamicSharedMemorySize, LDS_BYTES) != hipSuccess) { fprintf(stderr, "kernel_launch: hipFuncSetAttribute failed\n"); ready = -1; return; }
        int dev = 0, cus = 0, per_cu = 0;
        (void)hipGetDevice(&dev); (void)hipDeviceGetAttribute(&cus, hipDeviceAttributeMultiprocessorCount, dev);
        (void)hipOccupancyMaxActiveBlocksPerMultiprocessor(&per_cu, (const void*)hybrid_fwd, NWAVES * 64, LDS_BYTES);
        (void)hipGetLastError();
        if (cus != 256 || per_cu < 1) fprintf(stderr, "kernel_launch: note: %d CUs, %d workgroups per CU reported; this kernel is built for a 256-workgroup grid (one per CU)\n", cus, per_cu);
        ready = 1;
    }
    if (ready < 0) return;
    Args a{};
    for (int i = 0; i < 17; ++i) a.in[i] = (const float*)d_in[i];
    a.out = (float*)d_out; a.ws = (unsigned char*)d_ws;
#if MK_PER_PHASE
    for (int p = 0; p < N_PHASES; ++p) { a.ph_lo = p; a.ph_hi = p + 1; hipLaunchKernelGGL(hybrid_fwd, dim3(256), dim3(NWAVES * 64), LDS_BYTES, stream, a); }
#else
    a.ph_lo = 0; a.ph_hi = N_PHASES;
    void* kargs[] = {(void*)&a};
    const hipError_t e = hipLaunchCooperativeKernel((const void*)hybrid_fwd, dim3(256), dim3(NWAVES * 64), kargs, LDS_BYTES, stream);
    if (e != hipSuccess) fprintf(stderr, "kernel_launch: cooperative launch failed: %s\n", hipGetErrorString(e));
#endif
}
```
